# Optimizing an MI355X kernel written in HIP

```python
import jax, jax.numpy as jnp
from jax import lax
import numpy as np

D_MODEL = 1024
BATCH = 16
SEQ = 4096
DEPTH = 1
DEC_BATCH = 32
DEC_SEQ = 16
PAST_LEN = 1024

CHUNK = 64
N_HEADS = 16
HEAD_DIM = D_MODEL // N_HEADS
D_ATTN = N_HEADS * HEAD_DIM
D_CONV = D_MODEL
CONV_WIDTH = 3
D_FF = 4 * D_MODEL
Q_BLOCK = 128
RMS_EPS = 1e-6
N_PROJ = 3 * D_CONV + 3 * D_ATTN + 2 * D_MODEL
_SPLIT = [D_CONV, 2 * D_CONV, 3 * D_CONV,
          3 * D_CONV + D_ATTN, 3 * D_CONV + 2 * D_ATTN, 3 * D_CONV + 3 * D_ATTN,
          3 * D_CONV + 3 * D_ATTN + D_MODEL]

kernel_name = 'gated_conv_stickbreak_hybrid_step'


def _rmsnorm(x, g):
    x32 = x.astype(jnp.float32)
    y = x32 * lax.rsqrt(jnp.mean(x32 * x32, axis=-1, keepdims=True) + RMS_EPS)
    return (y * g.astype(jnp.float32)).astype(x.dtype)


def _project(xn, w_in):
    z = jnp.einsum('btd,dn->btn', xn, w_in)
    b_g, c_g, h, q, k, v, g_conv, g_attn = jnp.split(z, _SPLIT, axis=-1)
    bsz, t = xn.shape[0], xn.shape[1]
    q = q.reshape(bsz, t, N_HEADS, HEAD_DIM)
    k = k.reshape(bsz, t, N_HEADS, HEAD_DIM)
    v = v.reshape(bsz, t, N_HEADS, HEAD_DIM)
    return b_g, c_g, h, q, k, v, g_conv, g_attn


def _causal_conv(u_ext, conv_w, t):
    out = u_ext[:, 0:t] * conv_w[0]
    for i in range(1, CONV_WIDTH):
        out = out + u_ext[:, i:i + t] * conv_w[i]
    return out


def _stick_breaking(q, k, v, q_pos, k_pos):
    z = jnp.einsum('bqhd,bkhd->bhqk', q.astype(jnp.float32), k.astype(jnp.float32)) * (HEAD_DIM ** -0.5)
    mask = (k_pos[None, :] < q_pos[:, None])[None, None]
    log_rest = jnp.where(mask, jax.nn.log_sigmoid(-z), 0.0)
    suffix = lax.cumsum(log_rest, axis=3, reverse=True) - log_rest
    a = jnp.where(mask, jnp.exp(jax.nn.log_sigmoid(z) + suffix), 0.0)
    o = jnp.einsum('bhqk,bkhd->bqhd', a, v.astype(jnp.float32))
    return o.astype(v.dtype)


def _prompt_attention(q, k, v):
    bsz, s = q.shape[0], q.shape[1]
    nb = s // Q_BLOCK
    qb = jnp.moveaxis(q.reshape(bsz, nb, Q_BLOCK, N_HEADS, HEAD_DIM), 1, 0)
    pos = jnp.arange(s, dtype=jnp.int32)
    pb = pos.reshape(nb, Q_BLOCK)
    out = lax.map(lambda a: _stick_breaking(a[0], k, v, a[1], pos), (qb, pb))
    return jnp.moveaxis(out, 0, 1).reshape(bsz, s, N_HEADS, HEAD_DIM)


def _merge_ffn(x, conv_out, attn_out, g_conv, g_attn, w_out, g_ffn, w_up, w_down):
    bsz, t = x.shape[0], x.shape[1]
    mixed = jax.nn.sigmoid(g_conv) * conv_out + jax.nn.sigmoid(g_attn) * attn_out.reshape(bsz, t, D_ATTN)
    h = x + jnp.einsum('btc,cd->btd', mixed, w_out)
    up = jnp.einsum('btd,df->btf', _rmsnorm(h, g_ffn), w_up)
    return h + jnp.einsum('btf,fd->btd', jnp.square(jax.nn.relu(up)), w_down)


def setup_inputs(seed: int = 0) -> dict:
    key = jax.random.key(seed)
    ks = jax.random.split(key, 14)
    f32 = jnp.float32
    return {
        'x_prompt': jax.random.normal(ks[0], (BATCH, SEQ, D_MODEL), f32),
        'x_sample': jax.random.normal(ks[1], (DEC_BATCH, DEC_SEQ, D_MODEL), f32),
        'cache_conv': jax.random.normal(ks[2], (DEPTH, DEC_BATCH, CONV_WIDTH - 1, D_CONV), f32),
        'cache_k': jax.random.normal(ks[3], (DEPTH, DEC_BATCH, PAST_LEN, N_HEADS, HEAD_DIM), f32),
        'cache_v': jax.random.normal(ks[4], (DEPTH, DEC_BATCH, PAST_LEN, N_HEADS, HEAD_DIM), f32),
        'g_mix': 1.0 + 0.02 * jax.random.normal(ks[5], (DEPTH, D_MODEL), f32),
        'w_in': jax.random.normal(ks[6], (DEPTH, D_MODEL, N_PROJ), f32) * D_MODEL ** -0.5,
        'conv_w': jax.random.normal(ks[7], (DEPTH, CONV_WIDTH, D_CONV), f32) * CONV_WIDTH ** -0.5,
        'w_out': jax.random.normal(ks[8], (DEPTH, D_MODEL, D_MODEL), f32) * D_MODEL ** -0.5,
        'g_ffn': 1.0 + 0.02 * jax.random.normal(ks[9], (DEPTH, D_MODEL), f32),
        'w_up': jax.random.normal(ks[10], (DEPTH, D_MODEL, D_FF), f32) * D_MODEL ** -0.5,
        'w_down': jax.random.normal(ks[11], (DEPTH, D_FF, D_MODEL), f32) * D_FF ** -0.5,
        'g_final': 1.0 + 0.02 * jax.random.normal(ks[12], (D_MODEL,), f32),
    }


def reference(x_prompt, x_sample, cache_conv, cache_k, cache_v, g_mix, w_in, conv_w, w_out,
              g_ffn, w_up, w_down, g_final):
    xp, xs = x_prompt, x_sample
    seq = xp.shape[1]
    dec_seq = xs.shape[1]
    past = cache_k.shape[2]
    conv_p, k_p, v_p, conv_s, k_s, v_s = [], [], [], [], [], []
    for l in range(DEPTH):
        b_g, c_g, hc, q, k, v, g_c, g_a = _project(_rmsnorm(xp, g_mix[l]), w_in[l])
        u_ext = jnp.concatenate([jnp.zeros((xp.shape[0], CONV_WIDTH - 1, D_CONV), xp.dtype), c_g * hc], axis=1)
        conv_out = b_g * _causal_conv(u_ext, conv_w[l], seq)
        attn_out = _prompt_attention(q, k, v)
        conv_p.append(u_ext[:, -(CONV_WIDTH - 1):])
        k_p.append(k)
        v_p.append(v)
        xp = _merge_ffn(xp, conv_out, attn_out, g_c, g_a, w_out[l], g_ffn[l], w_up[l], w_down[l])
        b_g, c_g, hc, q, k, v, g_c, g_a = _project(_rmsnorm(xs, g_mix[l]), w_in[l])
        u_ext = jnp.concatenate([cache_conv[l].astype(xs.dtype), c_g * hc], axis=1)
        conv_out = b_g * _causal_conv(u_ext, conv_w[l], dec_seq)
        k_all = jnp.concatenate([cache_k[l].astype(k.dtype), k], axis=1)
        v_all = jnp.concatenate([cache_v[l].astype(v.dtype), v], axis=1)
        q_pos = past + jnp.arange(dec_seq, dtype=jnp.int32)
        k_pos = jnp.arange(past + dec_seq, dtype=jnp.int32)
        attn_out = _stick_breaking(q, k_all, v_all, q_pos, k_pos)
        conv_s.append(u_ext[:, -(CONV_WIDTH - 1):])
        k_s.append(k)
        v_s.append(v)
        xs = _merge_ffn(xs, conv_out, attn_out, g_c, g_a, w_out[l], g_ffn[l], w_up[l], w_down[l])
    y_prompt = _rmsnorm(xp, g_final)
    y_sample = _rmsnorm(xs, g_final)
    return (y_prompt, y_sample, jnp.stack(conv_p), jnp.stack(k_p), jnp.stack(v_p),
            jnp.stack(conv_s), jnp.stack(k_s), jnp.stack(v_s))
```

```cpp
#include <hip/hip_runtime.h>
#include <hip/hip_cooperative_groups.h>
#include <cstdio>
#include <cstdint>
namespace cg = cooperative_groups;

#define LAS __attribute__((address_space(3)))
typedef unsigned short bf16_t;
typedef short bf16x8 __attribute__((ext_vector_type(8)));
typedef short s16x4 __attribute__((ext_vector_type(4)));
typedef float f32x4 __attribute__((ext_vector_type(4)));
typedef float f32x2 __attribute__((ext_vector_type(2)));
typedef float f32x16 __attribute__((ext_vector_type(16)));
typedef unsigned u32x4 __attribute__((ext_vector_type(4)));
typedef unsigned u32x2 __attribute__((ext_vector_type(2)));
typedef __bf16 bf2_t __attribute__((ext_vector_type(2)));

constexpr int D = 1024, NPROJ = 8192, FF = 4096;
constexpr int MP = 65536, MS = 512, MT = MP + MS;
constexpr int SEQ = 4096, NBATCH = 16, DBATCH = 32, DSEQ = 16, PAST = 1024, NH = 16, HD = 64;
constexpr float RMS_EPS = 1e-6f;
constexpr float LOG2E = 1.4426950408889634f, LN2 = 0.6931471805599453f;

constexpr size_t OUT_Y = 0;
constexpr size_t OUT_CONVP = (size_t)MT * D;
constexpr size_t OUT_KP = OUT_CONVP + (size_t)NBATCH * 2 * D;
constexpr size_t OUT_VP = OUT_KP + (size_t)MP * D;
constexpr size_t OUT_CONVS = OUT_VP + (size_t)MP * D;
constexpr size_t OUT_KS = OUT_CONVS + (size_t)DBATCH * 2 * D;
constexpr size_t OUT_VS = OUT_KS + (size_t)MS * D;
constexpr size_t OUT_END = OUT_VS + (size_t)MS * D;

constexpr size_t MiB = 1u << 20;
constexpr size_t WS_SSQ1 = 0, WS_SSQ2 = 512 * 1024;
constexpr size_t WS_WIN = 1 * MiB, WS_WOUT = 17 * MiB, WS_WUP = 19 * MiB, WS_WDN = 27 * MiB;
constexpr size_t BUFSZ = (size_t)MT * D * 2;
constexpr size_t WS_XN = 36 * MiB;
constexpr size_t WS_U = WS_XN + BUFSZ, WS_MC = WS_U + BUFSZ, WS_SG = WS_MC + BUFSZ, WS_Q = WS_SG + BUFSZ, WS_KB = WS_Q + BUFSZ, WS_VB = WS_KB + BUFSZ;
constexpr size_t WS_ACT = WS_U;
constexpr size_t WS_END = WS_VB + BUFSZ;
static_assert((size_t)MT * FF * 2 == 4 * BUFSZ, "ACT overlay");

constexpr int NWAVES = 8, NTHREADS = 512;
constexpr int RING_BYTES = 131072, LDS_BYTES = 135168;

__device__ __forceinline__ unsigned pk2(float lo, float hi) { f32x2 v = {lo, hi}; bf2_t r = __builtin_convertvector(v, bf2_t); return __builtin_bit_cast(unsigned, r); }
__device__ __forceinline__ u32x4 pk8(f32x4 a, f32x4 b) { u32x4 w; w.x = pk2(a[0], a[1]); w.y = pk2(a[2], a[3]); w.z = pk2(b[0], b[1]); w.w = pk2(b[2], b[3]); return w; }
__device__ __forceinline__ float bf_lo(unsigned w) { return __builtin_bit_cast(float, w << 16); }
__device__ __forceinline__ float bf_hi(unsigned w) { return __builtin_bit_cast(float, w & 0xffff0000u); }
__device__ __forceinline__ float sigmoidf_(float x) { return __builtin_amdgcn_rcpf(1.0f + __builtin_amdgcn_exp2f(-x * LOG2E)); }
__device__ __forceinline__ f32x4 sigmoid4(f32x4 x) { f32x4 r; r[0] = sigmoidf_(x[0]); r[1] = sigmoidf_(x[1]); r[2] = sigmoidf_(x[2]); r[3] = sigmoidf_(x[3]); return r; }
__device__ __forceinline__ float wave_sum(float v) {
#pragma unroll
    for (int o = 1; o < 64; o <<= 1) v += __shfl_xor(v, o);
    return v;
}

namespace pg8 {
constexpr int BM = 256, BK = 64, HALF = 128, HTB = HALF * BK * 2, STAGE_BYTES = 8 * HTB, NXCD = 8, WGM = 8;
__host__ __device__ __forceinline__ int lds_byte(int r, int c) { const int st = (r >> 4) * 2 + (c >> 5), rr = r & 15, cc = c & 31, ob = rr * 64 + cc * 2; return st * 1024 + (ob ^ (((ob >> 9) & 1) << 5)); }
__host__ __device__ __forceinline__ void stage_rc(int b, int& R, int& C) { const int st = b / 1024, sb = b % 1024, swz = sb ^ (((sb >> 9) & 1) << 5); R = (st >> 1) * 16 + swz / 64; C = (st & 1) * 32 + (swz % 64) / 2; }
__host__ __device__ __forceinline__ int perm32(int rho) { const int n = rho >> 4, i = rho & 15; return 8 * (i >> 2) + 4 * n + (i & 3); }

struct Unit { int pm, pn; };
struct Gemm { const bf16_t* A; const bf16_t* Bt; int M, N, K; };

struct StaticOrder {
    int nM, nN, nwg, G, c;
    __device__ void init(int M, int N, int G_, int c_) { nM = M / BM; nN = N / BM; nwg = nM * nN; G = G_; c = c_; }
    __device__ bool next(int i, Unit& u) const {
        const long L = (long)i * G + c; if (L >= nwg) return false;
        int wgid = (int)L; { const int q = nwg / NXCD, r = nwg % NXCD, xcd = wgid % NXCD, off = wgid / NXCD; wgid = (xcd < r ? xcd * (q + 1) : r * (q + 1) + (xcd - r) * q) + off; }
        const int nig = WGM * nN, gid = wgid / nig, fm = gid * WGM, gsz = (nM - fm) < WGM ? (nM - fm) : WGM;
        u.pm = fm + ((wgid % nig) % gsz); u.pn = (wgid % nig) / gsz; return true;
    }
};


struct EpiIn {
    bf16_t *U, *MC, *SG, *Q, *KB, *VB; float* out;
    __device__ __forceinline__ void operator()(const f32x4 (&acc)[2][2][4][2], const Unit& u, int wr, int wc, int fr, int fq) const {
        const int type = u.pn >> 3, p = u.pn & 7;
        const int ch0 = 128 * p + 32 * wc + 8 * fq;
        const int row0 = u.pm * BM + wr * 64 + fr;
        const bool samp = u.pm >= (MP / BM);
        if (type == 0) {
#pragma unroll
            for (int ai = 0; ai < 2; ++ai)
#pragma unroll
                for (int m = 0; m < 4; ++m) {
                    const int row = row0 + ai * HALF + m * 16;
                    const f32x4 r0 = acc[ai][0][m][0] * acc[ai][1][m][0], r1 = acc[ai][0][m][1] * acc[ai][1][m][1];
                    *(u32x4*)(U + (size_t)row * D + ch0) = pk8(r0, r1);
                    int seqpos, seqlen, sb; float* cbase;
                    if (!samp) { seqpos = row & (SEQ - 1); seqlen = SEQ; sb = row >> 12; cbase = out + OUT_CONVP; }
                    else { const int rs = row - MP; seqpos = rs & (DSEQ - 1); seqlen = DSEQ; sb = rs >> 4; cbase = out + OUT_CONVS; }
                    if (seqpos >= seqlen - 2) { float* o = cbase + ((size_t)sb * 2 + (seqpos - (seqlen - 2))) * D + ch0; *(f32x4*)o = r0; *(f32x4*)(o + 4) = r1; }
                }
        } else if (type == 1) {
#pragma unroll
            for (int ai = 0; ai < 2; ++ai)
#pragma unroll
                for (int m = 0; m < 4; ++m) {
                    const int row = row0 + ai * HALF + m * 16;
                    const f32x4 r0 = acc[ai][0][m][0] * sigmoid4(acc[ai][1][m][0]), r1 = acc[ai][0][m][1] * sigmoid4(acc[ai][1][m][1]);
                    *(u32x4*)(MC + (size_t)row * D + ch0) = pk8(r0, r1);
                }
        } else if (type == 2) {
#pragma unroll
            for (int ai = 0; ai < 2; ++ai)
#pragma unroll
                for (int m = 0; m < 4; ++m) {
                    const int row = row0 + ai * HALF + m * 16;
                    *(u32x4*)(Q + (size_t)row * D + ch0) = pk8(acc[ai][0][m][0] * 0.125f, acc[ai][0][m][1] * 0.125f);
                    *(u32x4*)(SG + (size_t)row * D + ch0) = pk8(sigmoid4(acc[ai][1][m][0]), sigmoid4(acc[ai][1][m][1]));
                }
        } else {
            float* kout = samp ? out + OUT_KS - (size_t)MP * D : out + OUT_KP;
            float* vout = samp ? out + OUT_VS - (size_t)MP * D : out + OUT_VP;
#pragma unroll
            for (int ai = 0; ai < 2; ++ai)
#pragma unroll
                for (int m = 0; m < 4; ++m) {
                    const int row = row0 + ai * HALF + m * 16; const size_t off = (size_t)row * D + ch0;
                    *(f32x4*)(kout + off) = acc[ai][0][m][0]; *(f32x4*)(kout + off + 4) = acc[ai][0][m][1];
                    *(f32x4*)(vout + off) = acc[ai][1][m][0]; *(f32x4*)(vout + off + 4) = acc[ai][1][m][1];
                    *(u32x4*)(KB + off) = pk8(acc[ai][0][m][0], acc[ai][0][m][1]);
                    *(u32x4*)(VB + off) = pk8(acc[ai][1][m][0], acc[ai][1][m][1]);
                }
        }
    }
};

struct EpiOut {
    const float *xp, *xs; float* H; bf16_t* HB; float* ssq;
    __device__ __forceinline__ void operator()(const f32x4 (&acc)[2][2][4][2], const Unit& u, int wr, int wc, int fr, int fq) const {
        const int col0 = u.pn * BM + wc * 32 + 8 * fq, row0 = u.pm * BM + wr * 64 + fr;
        const float* xb = (u.pm >= (MP / BM)) ? xs - (size_t)MP * D : xp;
#pragma unroll
        for (int ai = 0; ai < 2; ++ai)
#pragma unroll
            for (int m = 0; m < 4; ++m) {
                const int row = row0 + ai * HALF + m * 16; float s = 0.f;
#pragma unroll
                for (int bj = 0; bj < 2; ++bj) {
                    const size_t off = (size_t)row * D + col0 + bj * HALF;
                    const f32x4 h0 = *(const f32x4*)(xb + off) + acc[ai][bj][m][0], h1 = *(const f32x4*)(xb + off + 4) + acc[ai][bj][m][1];
                    *(f32x4*)(H + off) = h0; *(f32x4*)(H + off + 4) = h1;
                    *(u32x4*)(HB + off) = pk8(h0, h1);
                    s += (h0[0] * h0[0] + h0[1] * h0[1]) + (h0[2] * h0[2] + h0[3] * h0[3]) + (h1[0] * h1[0] + h1[1] * h1[1]) + (h1[2] * h1[2] + h1[3] * h1[3]);
                }
                s += __shfl_xor(s, 16); s += __shfl_xor(s, 32);
                if (fq == 0) unsafeAtomicAdd(ssq + row, s);
            }
    }
};

struct EpiUp {
    bf16_t* ACT; const float* ssq;
    __device__ __forceinline__ void operator()(const f32x4 (&acc)[2][2][4][2], const Unit& u, int wr, int wc, int fr, int fq) const {
        const int col0 = u.pn * BM + wc * 32 + 8 * fq, row0 = u.pm * BM + wr * 64 + fr;
#pragma unroll
        for (int ai = 0; ai < 2; ++ai)
#pragma unroll
            for (int m = 0; m < 4; ++m) {
                const int row = row0 + ai * HALF + m * 16;
                const float rstd = __builtin_amdgcn_rsqf(ssq[row] * (1.0f / D) + RMS_EPS);
#pragma unroll
                for (int bj = 0; bj < 2; ++bj) {
                    f32x4 v0 = acc[ai][bj][m][0] * rstd, v1 = acc[ai][bj][m][1] * rstd;
                    v0 = __builtin_elementwise_max(v0, (f32x4){0.f, 0.f, 0.f, 0.f}); v1 = __builtin_elementwise_max(v1, (f32x4){0.f, 0.f, 0.f, 0.f});
                    *(u32x4*)(ACT + (size_t)row * FF + col0 + bj * HALF) = pk8(v0 * v0, v1 * v1);
                }
            }
    }
};

struct EpiDown {
    float* H; float* ssq;
    __device__ __forceinline__ void operator()(const f32x4 (&acc)[2][2][4][2], const Unit& u, int wr, int wc, int fr, int fq) const {
        const int col0 = u.pn * BM + wc * 32 + 8 * fq, row0 = u.pm * BM + wr * 64 + fr;
#pragma unroll
        for (int ai = 0; ai < 2; ++ai)
#pragma unroll
            for (int m = 0; m < 4; ++m) {
                const int row = row0 + ai * HALF + m * 16; float s = 0.f;
#pragma unroll
                for (int bj = 0; bj < 2; ++bj) {
                    const size_t off = (size_t)row * D + col0 + bj * HALF;
                    const f32x4 h0 = *(const f32x4*)(H + off) + acc[ai][bj][m][0], h1 = *(const f32x4*)(H + off + 4) + acc[ai][bj][m][1];
                    *(f32x4*)(H + off) = h0; *(f32x4*)(H + off + 4) = h1;
                    s += (h0[0] * h0[0] + h0[1] * h0[1]) + (h0[2] * h0[2] + h0[3] * h0[3]) + (h1[0] * h1[0] + h1[1] * h1[1]) + (h1[2] * h1[2] + h1[3] * h1[3]);
                }
                s += __shfl_xor(s, 16); s += __shfl_xor(s, 32);
                if (fq == 0) unsafeAtomicAdd(ssq + row, s);
            }
    }
};

template <class Epi>
__device__ __forceinline__ void gemm_phase(LAS unsigned char* lds, const Gemm g, const StaticOrder& S, const Epi& E) {
    const int tid = threadIdx.x, wid = __builtin_amdgcn_readfirstlane(tid >> 6), lane = tid & 63, wr = wid >> 2, wc = wid & 3, fr = lane & 15, fq = lane >> 4;
    const int K = g.K, nt = K / BK;
    unsigned voffA[2], voffB[2];
#pragma unroll
    for (int i = 0; i < 2; ++i) { int R, C; stage_rc(tid * 16 + i * 8192, R, C); const int Rb = (R & ~31) + perm32(R & 31);
        voffA[i] = (unsigned)(R * K + C) * 2u; voffB[i] = (unsigned)(Rb * K + C) * 2u; }
    const size_t kstep = (size_t)(BK * 2);
    const size_t hstep = (size_t)HALF * K * 2;
    const size_t tstep = 2 * hstep;
    const unsigned ldsw = (unsigned)wid * 1024u;
    const int aoff = lds_byte(wr * 64 + fr, fq * 8), boff = lds_byte(wc * 32 + fr, fq * 8);
#define PG8_SA(b, h) (((b) * 2 + (h)) * HTB)
#define PG8_SB(b, h) ((4 + (b) * 2 + (h)) * HTB)
#define PG8_STAGE(bufoff, gbase, voff) do { _Pragma("unroll") for (int _i = 0; _i < 2; ++_i) \
        __builtin_amdgcn_global_load_lds((const unsigned*)((const char*)(gbase) + (voff)[_i]), (LAS unsigned*)(lds + (bufoff) + ldsw + _i * 8192), 16, 0, 0); } while (0)
#define PG8_LDA(dst, b, h) do { _Pragma("unroll") for (int m = 0; m < 4; ++m) _Pragma("unroll") for (int k = 0; k < 2; ++k) dst[m][k] = *(const LAS bf16x8*)(lds + PG8_SA(b, h) + aoff + m * 2048 + k * 1024); } while (0)
#define PG8_LDB(dst, b, h) do { _Pragma("unroll") for (int n = 0; n < 2; ++n) _Pragma("unroll") for (int k = 0; k < 2; ++k) dst[n][k] = *(const LAS bf16x8*)(lds + PG8_SB(b, h) + boff + n * 2048 + k * 1024); } while (0)
#define PG8_MMA(ai, bj, At, Bt) do { __builtin_amdgcn_s_setprio(1); _Pragma("unroll") for (int m = 0; m < 4; ++m) _Pragma("unroll") for (int n = 0; n < 2; ++n) _Pragma("unroll") for (int k = 0; k < 2; ++k) \
        acc[ai][bj][m][n] = __builtin_amdgcn_mfma_f32_16x16x32_bf16(Bt[n][k], At[m][k], acc[ai][bj][m][n], 0, 0, 0); __builtin_amdgcn_s_setprio(0); } while (0)
#define PG8_WAIT_V(n) asm volatile("s_waitcnt vmcnt(" #n ")" ::: "memory")
#define PG8_WAIT_L(n) asm volatile("s_waitcnt lgkmcnt(" #n ")" ::: "memory")
#define PG8_BAR __builtin_amdgcn_s_barrier()
#define PG8_SCHED __builtin_amdgcn_sched_barrier(0)
    Unit cur, nxt; int ui = 0;
    if (!S.next(0, cur)) return;
    f32x4 acc[2][2][4][2];
#pragma unroll
    for (int a = 0; a < 2; ++a)
#pragma unroll
        for (int b = 0; b < 2; ++b)
#pragma unroll
            for (int m = 0; m < 4; ++m)
#pragma unroll
                for (int n = 0; n < 2; ++n) acc[a][b][m][n] = (f32x4){0.f, 0.f, 0.f, 0.f};
    bf16x8 At[4][2], B0[2][2], B1[2][2];
    const char* cA = (const char*)g.A + (size_t)cur.pm * tstep; const char* cB = (const char*)g.Bt + (size_t)cur.pn * tstep;
    PG8_STAGE(PG8_SB(0, 0), cB, voffB); PG8_STAGE(PG8_SB(0, 1), cB + hstep, voffB); PG8_STAGE(PG8_SA(0, 0), cA, voffA); PG8_STAGE(PG8_SA(0, 1), cA + hstep, voffA);
    if (wr == 1) PG8_BAR;
    PG8_WAIT_V(2); PG8_BAR;
    PG8_STAGE(PG8_SB(1, 0), cB + kstep, voffB); PG8_STAGE(PG8_SA(1, 0), cA + kstep, voffA); PG8_STAGE(PG8_SB(1, 1), cB + hstep + kstep, voffB);
    PG8_WAIT_V(6); PG8_BAR;
    for (;;) {
        const bool has_next = S.next(ui + 1, nxt);
        const char* nA = has_next ? (const char*)g.A + (size_t)nxt.pm * tstep : cA; const char* nB = has_next ? (const char*)g.Bt + (size_t)nxt.pn * tstep : cB;
        for (int t = 0; t < nt; t += 2) {
            const bool last = (t == nt - 2);
            const char* a1 = cA + (size_t)(t + 1) * kstep;
            const char* a2 = last ? nA : cA + (size_t)(t + 2) * kstep; const char* b2 = last ? nB : cB + (size_t)(t + 2) * kstep;
            const char* a3 = a2 + kstep; const char* b3 = b2 + kstep;
            PG8_LDB(B0, 0, 0); PG8_LDB(B1, 0, 1); PG8_SCHED; PG8_LDA(At, 0, 0); PG8_STAGE(PG8_SA(1, 1), a1 + hstep, voffA);
            PG8_WAIT_V(8); PG8_WAIT_L(0); PG8_BAR; PG8_MMA(0, 0, At, B0); PG8_MMA(0, 1, At, B1); PG8_BAR; PG8_SCHED;
            PG8_LDA(At, 0, 1); PG8_STAGE(PG8_SB(0, 0), b2, voffB); PG8_STAGE(PG8_SB(0, 1), b2 + hstep, voffB); PG8_STAGE(PG8_SA(0, 0), a2, voffA);
            PG8_WAIT_V(8); PG8_WAIT_L(0); PG8_BAR; PG8_MMA(1, 0, At, B0); PG8_MMA(1, 1, At, B1); PG8_BAR; PG8_SCHED;
            PG8_LDB(B0, 1, 0); PG8_LDB(B1, 1, 1); PG8_SCHED; PG8_LDA(At, 1, 0); PG8_STAGE(PG8_SA(0, 1), a2 + hstep, voffA);
            PG8_WAIT_V(8); PG8_WAIT_L(0); PG8_BAR; PG8_MMA(0, 0, At, B0); PG8_MMA(0, 1, At, B1); PG8_BAR; PG8_SCHED;
            PG8_LDA(At, 1, 1); PG8_STAGE(PG8_SB(1, 0), b3, voffB); PG8_STAGE(PG8_SB(1, 1), b3 + hstep, voffB); PG8_STAGE(PG8_SA(1, 0), a3, voffA);
            PG8_WAIT_V(8); PG8_WAIT_L(0); PG8_BAR; PG8_MMA(1, 0, At, B0); PG8_MMA(1, 1, At, B1); PG8_BAR; PG8_SCHED;
        }
        if (wr == 0) PG8_BAR;
        E(acc, cur, wr, wc, fr, fq);
        if (!has_next) break;
#pragma unroll
        for (int a = 0; a < 2; ++a)
#pragma unroll
            for (int b = 0; b < 2; ++b)
#pragma unroll
                for (int m = 0; m < 4; ++m)
#pragma unroll
                    for (int n = 0; n < 2; ++n) acc[a][b][m][n] = (f32x4){0.f, 0.f, 0.f, 0.f};
        cur = nxt; cA = nA; cB = nB; ++ui;
        if (wr == 1) PG8_BAR;
    }
    PG8_WAIT_V(0);
    PG8_BAR;
#undef PG8_SA
#undef PG8_SB
#undef PG8_STAGE
#undef PG8_LDA
#undef PG8_LDB
#undef PG8_MMA
#undef PG8_WAIT_V
#undef PG8_WAIT_L
#undef PG8_BAR
#undef PG8_SCHED
}
}

__device__ __forceinline__ void p0_transpose_item(const float* W, int K, int N, bf16_t* WT, int R0, int c0, int k0, const float* kscale, LAS float* scr, int lane) {
#pragma unroll 8
    for (int i = 0; i < 32; ++i) { const int kk = 2 * i + (lane >> 5); float v = W[(size_t)(k0 + kk) * N + c0 + (lane & 31)]; if (kscale) v *= kscale[k0 + kk]; scr[kk * 33 + (lane & 31)] = v; }
    asm volatile("s_waitcnt lgkmcnt(0)" ::: "memory");
    const int c = lane & 7;
#pragma unroll
    for (int j = 0; j < 4; ++j) { const int n = (lane >> 3) + 8 * j; const LAS float* s = scr + (8 * c) * 33 + n;
        u32x4 o; o.x = pk2(s[0 * 33], s[1 * 33]); o.y = pk2(s[2 * 33], s[3 * 33]); o.z = pk2(s[4 * 33], s[5 * 33]); o.w = pk2(s[6 * 33], s[7 * 33]);
        *(u32x4*)(WT + (size_t)(R0 + n) * K + k0 + 8 * c) = o; }
    asm volatile("s_waitcnt lgkmcnt(0)" ::: "memory");
}
__device__ __forceinline__ int win_src_col(int R) {
    const int pn = R >> 8, c = R & 255, bj = c >> 7, cc = c & 127, type = pn >> 3, p = pn & 7;
    int seg;
    if (type == 0) seg = bj ? 2 * D : 1 * D;
    else if (type == 1) seg = bj ? 6 * D : 0;
    else if (type == 2) seg = bj ? 7 * D : 3 * D;
    else seg = bj ? 5 * D : 4 * D;
    return seg + 128 * p + cc;
}
__device__ __forceinline__ void rms_row_to_bf16(const float* xrow, const float* g, bf16_t* orow, int lane) {
    const f32x4* xr = (const f32x4*)xrow + lane; const f32x4* gr = (const f32x4*)g + lane;
    f32x4 v[4]; float s = 0.f;
#pragma unroll
    for (int j = 0; j < 4; ++j) { v[j] = xr[64 * j]; s += (v[j][0] * v[j][0] + v[j][1] * v[j][1]) + (v[j][2] * v[j][2] + v[j][3] * v[j][3]); }
    const float rstd = __builtin_amdgcn_rsqf(wave_sum(s) * (1.f / D) + RMS_EPS);
    u32x2* o8 = (u32x2*)orow + lane;
#pragma unroll
    for (int j = 0; j < 4; ++j) { const f32x4 gv = gr[64 * j]; const f32x4 y = v[j] * rstd * gv; u32x2 w; w.x = pk2(y[0], y[1]); w.y = pk2(y[2], y[3]); o8[64 * j] = w; }
}

#define MFMA32(a, b, c) __builtin_amdgcn_mfma_f32_32x32x16_bf16((a), (b), (c), 0, 0, 0)
typedef short v4i16_t __attribute__((ext_vector_type(4)));
constexpr int VROW = 192;
constexpr int OROW = 272;
constexpr int QROW = 144;
constexpr int QOFF = 32 * VROW;
constexpr int ATT_WAVE_LDS = 16384;
static_assert(QOFF + 64 * QROW <= ATT_WAVE_LDS && 32 * OROW <= ATT_WAVE_LDS, "attention LDS map");
constexpr float R_STOP = -104.0f;

struct AttnPtrs {
    bf16_t *Q; const bf16_t *KB, *VB, *U, *MC, *SG; const float *cache_k, *cache_v, *cache_conv, *conv_w;
};

__device__ __forceinline__ bf16x8 cvt8(const float* p) { const f32x4 a = *(const f32x4*)p, b = *(const f32x4*)(p + 4); return __builtin_bit_cast(bf16x8, pk8(a, b)); }

template <bool SAMPLE>
__device__ __forceinline__ void attn_unit(const AttnPtrs& T, int b, int h, int qb, LAS unsigned char* wl, int lane) {
    constexpr int NQT = SAMPLE ? 1 : 2;
    const int r32 = lane & 31, hh = lane >> 5;
    const int rowbase = SAMPLE ? (MP + b * DSEQ) : (b * SEQ);
    const int q0 = SAMPLE ? 0 : qb * 64;
    const int posoff = SAMPLE ? PAST : 0;
    int qidx[NQT];
    LAS unsigned char* ql = wl + QOFF;
#pragma unroll
    for (int qt = 0; qt < NQT; ++qt) {
        int qi = q0 + 32 * qt + r32; if (SAMPLE) qi = qi < DSEQ ? qi : DSEQ - 1;
        qidx[qt] = qi;
    }
#pragma unroll
    for (int i = 0; i < 4 * NQT; ++i) {
        const int idx = lane + 64 * i, qr = idx >> 3, ck = idx & 7;
        int qi = q0 + qr; if (SAMPLE) qi = qi < DSEQ ? qi : DSEQ - 1;
        *(LAS bf16x8*)(ql + qr * QROW + ck * 16) = *(const bf16x8*)(T.Q + (size_t)(rowbase + qi) * D + h * HD + 8 * ck);
    }
    const LAS unsigned char* qrd = ql + r32 * QROW + 16 * hh;
    f32x16 oacc[2][NQT];
#pragma unroll
    for (int dt = 0; dt < 2; ++dt)
#pragma unroll
        for (int qt = 0; qt < NQT; ++qt)
#pragma unroll
            for (int i = 0; i < 16; ++i) oacc[dt][qt][i] = 0.f;
    float Rq[NQT]; bool done[NQT];
#pragma unroll
    for (int qt = 0; qt < NQT; ++qt) { Rq[qt] = 0.f; done[qt] = false; }

    const int jq0 = (posoff + q0) >> 5;
    const int jmax = jq0 + NQT - 1;

    bf16x8 kf[4], vr[4];
    auto load_tile = [&](int j) {
        if (SAMPLE && j < (PAST >> 5)) {
            const float* kp = T.cache_k + (((size_t)b * PAST + 32 * j + r32) * NH + h) * HD + 8 * hh;
#pragma unroll
            for (int ks = 0; ks < 4; ++ks) kf[ks] = cvt8(kp + 16 * ks);
#pragma unroll
            for (int i = 0; i < 4; ++i) { const int idx = lane + 64 * i, key = idx >> 3, ck = idx & 7;
                vr[i] = cvt8(T.cache_v + (((size_t)b * PAST + 32 * j + key) * NH + h) * HD + 8 * ck); }
        } else {
            int kidx = 32 * j - posoff + r32; if (SAMPLE) kidx = kidx < DSEQ ? kidx : DSEQ - 1;
            const bf16_t* kp = T.KB + (size_t)(rowbase + kidx) * D + h * HD + 8 * hh;
#pragma unroll
            for (int ks = 0; ks < 4; ++ks) kf[ks] = *(const bf16x8*)(kp + 16 * ks);
#pragma unroll
            for (int i = 0; i < 4; ++i) { const int idx = lane + 64 * i, key = idx >> 3, ck = idx & 7;
                int vidx = 32 * j - posoff + key; if (SAMPLE) vidx = vidx < DSEQ ? vidx : DSEQ - 1;
                vr[i] = *(const bf16x8*)(T.VB + (size_t)(rowbase + vidx) * D + h * HD + 8 * ck); }
        }
    };
    load_tile(jmax);
    const int i16 = lane & 15, blk = (lane >> 4) & 1;
    const unsigned vrd = (unsigned)(4 * hh + (i16 >> 2)) * VROW + (unsigned)(16 * blk + 4 * (i16 & 3)) * 2u;

    for (int j = jmax; j >= 0; --j) {
        bool act[NQT]; bool any = false;
#pragma unroll
        for (int qt = 0; qt < NQT; ++qt) { act[qt] = (j <= jq0 + qt) && !done[qt]; any = any || act[qt]; }
        if (!any) break;
        bf16x8 kc[4];
#pragma unroll
        for (int ks = 0; ks < 4; ++ks) kc[ks] = kf[ks];
#pragma unroll
        for (int i = 0; i < 4; ++i) { const int idx = lane + 64 * i, key = idx >> 3, ck = idx & 7; *(LAS bf16x8*)(wl + key * VROW + ck * 16) = vr[i]; }
        if (j > 0) load_tile(j - 1);
        __builtin_amdgcn_wave_barrier();
        bf16x8 vf[2][2];
#pragma unroll
        for (int dt = 0; dt < 2; ++dt)
#pragma unroll
            for (int s = 0; s < 2; ++s) {
                const LAS unsigned char* pa = wl + vrd + (16 * s) * VROW + dt * 64;
                const s16x4 lo = __builtin_bit_cast(s16x4, __builtin_amdgcn_ds_read_tr16_b64_v4i16((LAS v4i16_t*)pa));
                const s16x4 hi = __builtin_bit_cast(s16x4, __builtin_amdgcn_ds_read_tr16_b64_v4i16((LAS v4i16_t*)(pa + 8 * VROW)));
                vf[dt][s] = __builtin_shufflevector(lo, hi, 0, 1, 2, 3, 4, 5, 6, 7);
            }
#pragma unroll
        for (int qt = 0; qt < NQT; ++qt) {
            if (!act[qt]) continue;
            f32x16 z;
#pragma unroll
            for (int i = 0; i < 16; ++i) z[i] = 0.f;
#pragma unroll
            for (int ks = 0; ks < 4; ++ks) z = MFMA32(kc[ks], *(const LAS bf16x8*)(qrd + (32 * qt) * QROW + 32 * ks), z);
            const int tpos = posoff + qidx[qt];
            const int kb = 32 * j + 4 * hh;
            const bool diag = (j == jq0 + qt);
            float L[16];
#pragma unroll
            for (int r = 0; r < 16; ++r) {
                const float zz = z[r];
                const float e = __builtin_amdgcn_exp2f(-__builtin_fabsf(zz) * LOG2E);
                const float sp = __builtin_fmaxf(zz, 0.f) + __builtin_amdgcn_logf(1.0f + e) * LN2;
                const int spos = kb + (r & 3) + 8 * (r >> 2);
                L[r] = (!diag || spos < tpos) ? -sp : 0.f;
            }
            float S[4], So[4];
#pragma unroll
            for (int gq = 0; gq < 4; ++gq) { S[gq] = (L[4 * gq] + L[4 * gq + 1]) + (L[4 * gq + 2] + L[4 * gq + 3]); So[gq] = __shfl_xor(S[gq], 32); }
            float after = Rq[qt];
            f32x16 P;
#pragma unroll
            for (int gq = 3; gq >= 0; --gq) {
                float c = after + (hh == 0 ? So[gq] : 0.f);
#pragma unroll
                for (int i = 3; i >= 0; --i) {
                    const int r = 4 * gq + i;
                    c += L[r];
                    const int spos = kb + (r & 3) + 8 * (r >> 2);
                    const float pv = __builtin_amdgcn_exp2f((z[r] + c) * LOG2E);
                    P[r] = (!diag || spos < tpos) ? pv : 0.f;
                }
                after += S[gq] + So[gq];
            }
            Rq[qt] = after;
            done[qt] = __all(after < R_STOP);
#pragma unroll
            for (int s = 0; s < 2; ++s) {
                u32x4 pw; pw.x = pk2(P[8 * s], P[8 * s + 1]); pw.y = pk2(P[8 * s + 2], P[8 * s + 3]); pw.z = pk2(P[8 * s + 4], P[8 * s + 5]); pw.w = pk2(P[8 * s + 6], P[8 * s + 7]);
                const bf16x8 pf = __builtin_bit_cast(bf16x8, pw);
#pragma unroll
                for (int dt = 0; dt < 2; ++dt) oacc[dt][qt] = MFMA32(vf[dt][s], pf, oacc[dt][qt]);
            }
        }
        __builtin_amdgcn_wave_barrier();
    }

    const int c8 = lane & 7, rsub = lane >> 3;
    const int ch = h * HD + 8 * c8;
    f32x4 w0a = *(const f32x4*)(T.conv_w + ch), w0b = *(const f32x4*)(T.conv_w + ch + 4);
    f32x4 w1a = *(const f32x4*)(T.conv_w + D + ch), w1b = *(const f32x4*)(T.conv_w + D + ch + 4);
    f32x4 w2a = *(const f32x4*)(T.conv_w + 2 * D + ch), w2b = *(const f32x4*)(T.conv_w + 2 * D + ch + 4);
#pragma unroll
    for (int qt = 0; qt < NQT; ++qt) {
        asm volatile("" ::: "memory"); __builtin_amdgcn_wave_barrier();
#pragma unroll
        for (int dt = 0; dt < 2; ++dt)
#pragma unroll
            for (int gq = 0; gq < 4; ++gq) {
                const f32x4 v = {oacc[dt][qt][4 * gq], oacc[dt][qt][4 * gq + 1], oacc[dt][qt][4 * gq + 2], oacc[dt][qt][4 * gq + 3]};
                *(LAS f32x4*)(wl + r32 * OROW + (32 * dt + 8 * gq + 4 * hh) * 4) = v;
            }
        asm volatile("" ::: "memory"); __builtin_amdgcn_wave_barrier();
        constexpr int NPASS = SAMPLE ? 2 : 4;
#pragma unroll
        for (int ps = 0; ps < NPASS; ++ps) {
            const int ql = ps * 8 + rsub;
            const int qi = q0 + 32 * qt + ql;
            const size_t row = (size_t)(rowbase + qi);
            const f32x4 oa = *(const LAS f32x4*)(wl + ql * OROW + c8 * 32), ob = *(const LAS f32x4*)(wl + ql * OROW + c8 * 32 + 16);
            const u32x4 sg = *(const u32x4*)(T.SG + row * D + ch), mc = *(const u32x4*)(T.MC + row * D + ch), u0 = *(const u32x4*)(T.U + row * D + ch);
            f32x4 u1a, u1b, u2a, u2b;
            if (qi >= 1) { const u32x4 t = *(const u32x4*)(T.U + (row - 1) * D + ch); u1a = (f32x4){bf_lo(t.x), bf_hi(t.x), bf_lo(t.y), bf_hi(t.y)}; u1b = (f32x4){bf_lo(t.z), bf_hi(t.z), bf_lo(t.w), bf_hi(t.w)}; }
            else if (SAMPLE) { const float* cp = T.cache_conv + ((size_t)b * 2 + 1) * D + ch; u1a = *(const f32x4*)cp; u1b = *(const f32x4*)(cp + 4); }
            else { u1a = (f32x4){0.f, 0.f, 0.f, 0.f}; u1b = u1a; }
            if (qi >= 2) { const u32x4 t = *(const u32x4*)(T.U + (row - 2) * D + ch); u2a = (f32x4){bf_lo(t.x), bf_hi(t.x), bf_lo(t.y), bf_hi(t.y)}; u2b = (f32x4){bf_lo(t.z), bf_hi(t.z), bf_lo(t.w), bf_hi(t.w)}; }
            else if (SAMPLE) { const float* cp = T.cache_conv + ((size_t)b * 2 + qi) * D + ch; u2a = *(const f32x4*)cp; u2b = *(const f32x4*)(cp + 4); }
            else { u2a = (f32x4){0.f, 0.f, 0.f, 0.f}; u2b = u2a; }
            const f32x4 u0a = {bf_lo(u0.x), bf_hi(u0.x), bf_lo(u0.y), bf_hi(u0.y)}, u0b = {bf_lo(u0.z), bf_hi(u0.z), bf_lo(u0.w), bf_hi(u0.w)};
            const f32x4 sga = {bf_lo(sg.x), bf_hi(sg.x), bf_lo(sg.y), bf_hi(sg.y)}, sgb = {bf_lo(sg.z), bf_hi(sg.z), bf_lo(sg.w), bf_hi(sg.w)};
            const f32x4 mca = {bf_lo(mc.x), bf_hi(mc.x), bf_lo(mc.y), bf_hi(mc.y)}, mcb = {bf_lo(mc.z), bf_hi(mc.z), bf_lo(mc.w), bf_hi(mc.w)};
            const f32x4 ma = sga * oa + mca * (w0a * u2a + w1a * u1a + w2a * u0a);
            const f32x4 mb = sgb * ob + mcb * (w0b * u2b + w1b * u1b + w2b * u0b);
            *(u32x4*)(T.Q + row * D + ch) = pk8(ma, mb);
        }
    }
    asm volatile("" ::: "memory"); __builtin_amdgcn_wave_barrier();
}

struct Args { const float* in[13]; float* out; unsigned char* ws; };

__global__ void __launch_bounds__(NTHREADS, 2) mk_fwd(Args a) {
    extern __shared__ __attribute__((aligned(16))) unsigned char lds_raw[];
    LAS unsigned char* lds = (LAS unsigned char*)lds_raw;
    cg::grid_group grid = cg::this_grid();
    const int tid = threadIdx.x, lane = tid & 63, wave = __builtin_amdgcn_readfirstlane(tid >> 6);
    const int G = gridDim.x, bx = blockIdx.x;
    const int gw = bx * NWAVES + wave, NGW = G * NWAVES;

    const float* x_prompt = a.in[0]; const float* x_sample = a.in[1]; const float* cache_conv = a.in[2]; const float* cache_k = a.in[3]; const float* cache_v = a.in[4];
    const float* g_mix = a.in[5]; const float* w_in = a.in[6]; const float* conv_w = a.in[7]; const float* w_out = a.in[8]; const float* g_ffn = a.in[9];
    const float* w_up = a.in[10]; const float* w_down = a.in[11]; const float* g_final = a.in[12];
    unsigned char* ws = a.ws; float* out = a.out;
    float* ssq1 = (float*)(ws + WS_SSQ1); float* ssq2 = (float*)(ws + WS_SSQ2);
    bf16_t* Win_t = (bf16_t*)(ws + WS_WIN); bf16_t* Wout_t = (bf16_t*)(ws + WS_WOUT); bf16_t* Wup_t = (bf16_t*)(ws + WS_WUP); bf16_t* Wdn_t = (bf16_t*)(ws + WS_WDN);
    bf16_t* XN = (bf16_t*)(ws + WS_XN); bf16_t* HB = XN;
    bf16_t* U = (bf16_t*)(ws + WS_U); bf16_t* MC = (bf16_t*)(ws + WS_MC); bf16_t* SG = (bf16_t*)(ws + WS_SG); bf16_t* Q = (bf16_t*)(ws + WS_Q);
    bf16_t* KB = (bf16_t*)(ws + WS_KB); bf16_t* VB = (bf16_t*)(ws + WS_VB); bf16_t* ACT = (bf16_t*)(ws + WS_ACT);

    {
        LAS float* scr = (LAS float*)(lds + wave * 16384);
        constexpr int I_IN = (D / 64) * (NPROJ / 32), I_OUT = (D / 64) * (D / 32), I_UP = (D / 64) * (FF / 32), I_DN = (FF / 64) * (D / 32);
        constexpr int NITEMS = I_IN + I_OUT + I_UP + I_DN;
        for (int it = gw; it < NITEMS; it += NGW) {
            int r = it;
            if (r < I_IN) { const int nb = r % (NPROJ / 32), kb = r / (NPROJ / 32); p0_transpose_item(w_in, D, NPROJ, Win_t, 32 * nb, win_src_col(32 * nb), 64 * kb, nullptr, scr, lane); continue; } r -= I_IN;
            if (r < I_OUT) { const int nb = r % (D / 32), kb = r / (D / 32); p0_transpose_item(w_out, D, D, Wout_t, 32 * nb, 32 * nb, 64 * kb, nullptr, scr, lane); continue; } r -= I_OUT;
            if (r < I_UP) { const int nb = r % (FF / 32), kb = r / (FF / 32); p0_transpose_item(w_up, D, FF, Wup_t, 32 * nb, 32 * nb, 64 * kb, g_ffn, scr, lane); continue; } r -= I_UP;
            { const int nb = r % (D / 32), kb = r / (D / 32); p0_transpose_item(w_down, FF, D, Wdn_t, 32 * nb, 32 * nb, 64 * kb, nullptr, scr, lane); }
        }
        for (int m = gw; m < MT; m += NGW) {
            const float* xr = m < MP ? x_prompt + (size_t)m * D : x_sample + (size_t)(m - MP) * D;
            rms_row_to_bf16(xr, g_mix, XN + (size_t)m * D, lane);
        }
        for (int i = bx * NTHREADS + tid; i < MT; i += G * NTHREADS) { ssq1[i] = 0.f; ssq2[i] = 0.f; }
    }
    grid.sync();

    {
        pg8::Gemm g{XN, Win_t, MT, NPROJ, D}; pg8::StaticOrder S; S.init(MT, NPROJ, G, bx);
        pg8::EpiIn E{U, MC, SG, Q, KB, VB, out};
        pg8::gemm_phase<pg8::EpiIn>(lds, g, S, E);
    }
    grid.sync();

    {
        AttnPtrs T{Q, KB, VB, U, MC, SG, cache_k, cache_v, cache_conv, conv_w};
        LAS unsigned char* wl = lds + wave * ATT_WAVE_LDS;
        constexpr int NUP = NBATCH * NH * (SEQ / 64), NUS = DBATCH * NH;
        for (int un = gw; un < NUP + NUS; un += NGW) {
            if (un < NUP) { const int qb = un & 63, h = (un >> 6) & 15, b = un >> 10; attn_unit<false>(T, b, h, qb, wl, lane); }
            else { const int us = un - NUP, h = us & 15, b = us >> 4; attn_unit<true>(T, b, h, 0, wl, lane); }
        }
    }
    grid.sync();

    {
        pg8::Gemm g{Q, Wout_t, MT, D, D}; pg8::StaticOrder S; S.init(MT, D, G, bx);
        pg8::EpiOut E{x_prompt, x_sample, out + OUT_Y, HB, ssq1};
        pg8::gemm_phase<pg8::EpiOut>(lds, g, S, E);
    }
    grid.sync();

    {
        pg8::Gemm g{HB, Wup_t, MT, FF, D}; pg8::StaticOrder S; S.init(MT, FF, G, bx);
        pg8::EpiUp E{ACT, ssq1};
        pg8::gemm_phase<pg8::EpiUp>(lds, g, S, E);
    }
    grid.sync();

    {
        pg8::Gemm g{ACT, Wdn_t, MT, D, FF}; pg8::StaticOrder S; S.init(MT, D, G, bx);
        pg8::EpiDown E{out + OUT_Y, ssq2};
        pg8::gemm_phase<pg8::EpiDown>(lds, g, S, E);
    }
    grid.sync();

    for (int m = gw; m < MT; m += NGW) {
        f32x4* yr = (f32x4*)(out + OUT_Y + (size_t)m * D) + lane; const f32x4* gr = (const f32x4*)g_final + lane;
        const float rstd = __builtin_amdgcn_rsqf(ssq2[m] * (1.f / D) + RMS_EPS);
#pragma unroll
        for (int j = 0; j < 4; ++j) yr[64 * j] = yr[64 * j] * rstd * gr[64 * j];
    }
}

extern "C" void kernel_launch(void* const* d_in, const int* in_sizes, int n_in, void* d_out, int out_size, void* d_ws, size_t ws_size, hipStream_t stream) {
    static int grid = 0;
    if (grid == 0) {
        if (n_in != 13 || (size_t)out_size != OUT_END || ws_size < WS_END) { fprintf(stderr, "kernel_launch: unexpected shapes (n_in %d out %d ws %zu need %zu)\n", n_in, out_size, ws_size, (size_t)WS_END); grid = -1; return; }
        int dev = 0, cus = 0, per_cu = 0;
        hipGetDevice(&dev); hipDeviceGetAttribute(&cus, hipDeviceAttributeMultiprocessorCount, dev);
        if (hipFuncSetAttribute((const void*)mk_fwd, hipFuncAttributeMaxDynamicSharedMemorySize, LDS_BYTES) != hipSuccess) { fprintf(stderr, "kernel_launch: hipFuncSetAttribute failed\n"); grid = -1; return; }
        hipOccupancyMaxActiveBlocksPerMultiprocessor(&per_cu, (const void*)mk_fwd, NTHREADS, LDS_BYTES);
        (void)hipGetLastError();
        if (per_cu < 1) { fprintf(stderr, "kernel_launch: occupancy query says 0 blocks per CU\n"); per_cu = 1; }
        grid = cus;
    }
    if (grid < 0) return;
    Args a{};
    for (int i = 0; i < 13; ++i) a.in[i] = (const float*)d_in[i];
    a.out = (float*)d_out; a.ws = (unsigned char*)d_ws;
    void* args[] = {&a};
    hipError_t e = hipLaunchCooperativeKernel((const void*)mk_fwd, dim3(grid), dim3(NTHREADS), args, LDS_BYTES, stream);
    if (e != hipSuccess) fprintf(stderr, "kernel_launch: cooperative launch failed: %s (grid %d)\n", hipGetErrorString(e), grid);
}
```
